# Optimizing an MI355X kernel written in HIP

```python
import jax, jax.numpy as jnp
from jax import lax
import numpy as np

D_MODEL = 2048
BATCH = 2
SEQ = 4096
DEPTH = 1

EPS = 1e-6
N_HEADS = 16
QK_NOPE = 128
QK_ROPE = 64
V_HEAD = 128
Q_LORA = 512
KV_LORA = 512
MLA_WIDTH = N_HEADS * V_HEAD
ROPE_THETA = 10000.0
Q_BLOCK = 128
POOL_WINDOWS = (2, 4, 8, 16)
POOL_GROUPS = len(POOL_WINDOWS)
POOL_GROUP_DIM = 256
POOL_WIDTH = POOL_GROUPS * POOL_GROUP_DIM
IN_SPLITS = (Q_LORA, KV_LORA, QK_ROPE, MLA_WIDTH, POOL_WIDTH, POOL_WIDTH, D_MODEL, D_MODEL)
N_IN = sum(IN_SPLITS)
IN_OFFSETS = tuple(int(v) for v in np.cumsum(IN_SPLITS)[:-1])

kernel_name = "hybrid_mla_pool_gated_encoder_block"


def _rmsnorm(x, g):
    xf = x.astype(jnp.float32)
    y = xf * lax.rsqrt(jnp.mean(xf * xf, axis=-1, keepdims=True) + EPS)
    return y.astype(x.dtype) * g


def _rope_tables(positions, dtype):
    inv_freq = 1.0 / (ROPE_THETA ** (jnp.arange(0, QK_ROPE, 2, dtype=jnp.float32) / QK_ROPE))
    ang = positions.astype(jnp.float32)[..., None] * inv_freq
    return jnp.cos(ang).astype(dtype), jnp.sin(ang).astype(dtype)


def _apply_rope(x, cos, sin):
    x1, x2 = jnp.split(x, 2, axis=-1)
    return jnp.concatenate([x1 * cos - x2 * sin, x2 * cos + x1 * sin], axis=-1)


def _mla_attention(q_nope, q_rope, k_nope, k_rope, v):
    B, S, H, _ = q_nope.shape
    n_blocks = S // Q_BLOCK
    scale = (QK_NOPE + QK_ROPE) ** -0.5

    def block(i):
        start = i * Q_BLOCK
        qn = lax.dynamic_slice_in_dim(q_nope, start, Q_BLOCK, axis=1)
        qr = lax.dynamic_slice_in_dim(q_rope, start, Q_BLOCK, axis=1)
        s = (jnp.einsum('bqhn,bkhn->bhqk', qn, k_nope)
             + jnp.einsum('bqhr,bkr->bhqk', qr, k_rope))
        p = jax.nn.softmax(s.astype(jnp.float32) * scale, axis=-1).astype(v.dtype)
        return jnp.einsum('bhqk,bkhv->bqhv', p, v)

    o = lax.map(block, jnp.arange(n_blocks))
    return jnp.moveaxis(o, 0, 1).reshape(B, S, H * V_HEAD)


def _multiscale_pool(v):
    S = v.shape[1]
    vf = v.astype(jnp.float32)
    cs = jnp.concatenate([jnp.zeros_like(vf[:, :1]), jnp.cumsum(vf, axis=1)], axis=1)
    t = jnp.arange(S)[:, None]
    w = jnp.array(POOL_WINDOWS, dtype=jnp.int32)[None, :]
    lo = jnp.clip(t - w // 2, 0, S)
    hi = jnp.clip(t + w - w // 2, 0, S)
    g = jnp.arange(POOL_GROUPS)[None, :]
    window_sum = cs[:, hi, g] - cs[:, lo, g]
    count = (hi - lo).astype(jnp.float32)[None, :, :, None]
    return (window_sum / count - vf).astype(v.dtype)


def setup_inputs(seed: int = 0) -> dict:
    key = jax.random.key(seed)
    ks = jax.random.split(key, 20)
    f32 = jnp.float32

    def w(k, shape, fan_in):
        return jax.random.normal(k, shape, f32) * (fan_in ** -0.5)

    def gain(k, shape):
        return 1.0 + 0.02 * jax.random.normal(k, shape, f32)

    x = jax.random.normal(ks[0], (BATCH, SEQ, D_MODEL), f32)
    c = jax.random.normal(ks[1], (BATCH, D_MODEL), f32)
    offsets = jax.random.randint(ks[2], (BATCH, 1), 0, 1024, dtype=jnp.int32)
    positions = offsets + jnp.arange(SEQ, dtype=jnp.int32)[None, :]
    return {
        "x": x,
        "c": c,
        "positions": positions,
        "ada_w": w(ks[3], (DEPTH, D_MODEL, 3 * D_MODEL), D_MODEL),
        "ada_b": 0.02 * jax.random.normal(ks[4], (DEPTH, 3 * D_MODEL), f32),
        "norm_g": gain(ks[5], (DEPTH, D_MODEL)),
        "w_in": w(ks[6], (DEPTH, D_MODEL, N_IN), D_MODEL),
        "q_norm_g": gain(ks[7], (DEPTH, Q_LORA)),
        "w_uq": w(ks[8], (DEPTH, Q_LORA, N_HEADS * (QK_NOPE + QK_ROPE)), Q_LORA),
        "kv_norm_g": gain(ks[9], (DEPTH, KV_LORA)),
        "w_ukv": w(ks[10], (DEPTH, KV_LORA, N_HEADS * (QK_NOPE + V_HEAD)), KV_LORA),
        "w_o_mla": w(ks[11], (DEPTH, MLA_WIDTH, D_MODEL), MLA_WIDTH),
        "pool_w": w(ks[12], (DEPTH, POOL_GROUPS, POOL_GROUP_DIM, POOL_GROUP_DIM), POOL_GROUP_DIM),
        "pool_scale": 1.0 + 0.1 * jax.random.normal(ks[13], (DEPTH, POOL_WIDTH), f32),
        "w_o_pool": w(ks[14], (DEPTH, POOL_WIDTH, D_MODEL), POOL_WIDTH),
        "w_out": w(ks[15], (DEPTH, D_MODEL, D_MODEL), D_MODEL),
        "final_g": gain(ks[16], (D_MODEL,)),
    }


def reference(x, c, positions, ada_w, ada_b, norm_g, w_in, q_norm_g, w_uq, kv_norm_g,
              w_ukv, w_o_mla, pool_w, pool_scale, w_o_pool, w_out, final_g):
    B, S, D = x.shape
    cos, sin = _rope_tables(positions, x.dtype)
    c_act = jax.nn.silu(c)
    for l in range(DEPTH):
        mod = c_act @ ada_w[l] + ada_b[l]
        shift, scale, gate = jnp.split(mod, 3, axis=-1)
        h = _rmsnorm(x, norm_g[l]) * (1.0 + scale[:, None, :]) + shift[:, None, :]

        z = h @ w_in[l]
        c_q, c_kv, k_rope, g_mla, v_pool, g_pool, m_mla, m_pool = jnp.split(z, IN_OFFSETS, axis=-1)

        q = (_rmsnorm(c_q, q_norm_g[l]) @ w_uq[l]).reshape(B, S, N_HEADS, QK_NOPE + QK_ROPE)
        q_nope, q_rope = q[..., :QK_NOPE], q[..., QK_NOPE:]
        q_rope = _apply_rope(q_rope, cos[:, :, None, :], sin[:, :, None, :])
        kv = (_rmsnorm(c_kv, kv_norm_g[l]) @ w_ukv[l]).reshape(B, S, N_HEADS, QK_NOPE + V_HEAD)
        k_nope, v = kv[..., :QK_NOPE], kv[..., QK_NOPE:]
        k_rope = _apply_rope(k_rope, cos, sin)
        attn = _mla_attention(q_nope, q_rope, k_nope, k_rope, v)
        p_mla = (attn * jax.nn.silu(g_mla)) @ w_o_mla[l]

        vp = v_pool.reshape(B, S, POOL_GROUPS, POOL_GROUP_DIM)
        pooled = _multiscale_pool(vp)
        mixed = jnp.einsum('bsgc,gcd->bsgd', pooled, pool_w[l]).reshape(B, S, POOL_WIDTH)
        p_pool = (mixed * pool_scale[l] * jax.nn.silu(g_pool)) @ w_o_pool[l]

        y = jax.nn.sigmoid(m_mla) * p_mla + jax.nn.sigmoid(m_pool) * p_pool
        x = x + gate[:, None, :] * (y @ w_out[l])
    return _rmsnorm(x, final_g)
```

```cpp
#include <hip/hip_runtime.h>
#include <hip/hip_bf16.h>
#include <cstdio>
#include <cstdint>

#ifndef MK_N_LAUNCHES
#define MK_N_LAUNCHES 8
#endif

constexpr int BATCH = 2, SEQ = 4096, DM = 2048, MROWS = BATCH * SEQ;
constexpr int NH = 16, QL = 512, KVL = 512, QHD = 192, KVHD = 256;
constexpr int NQ = NH * QHD, NKV = NH * KVHD;
constexpr int PW = 1024;
constexpr int NIN = 9280, NINP = 9472;
constexpr int NMOD = 3 * DM;
constexpr float EPS = 1e-6f;
constexpr int ADA_KC = 16, ADA_KCH = DM / ADA_KC;
constexpr float QSCALE_LOG2E = 0.07216878364870322f * 1.4426950408889634f;

constexpr size_t MiB = 1u << 20;
constexpr size_t WS_CTL = 0, CTL_ZERO_BYTES = 1 * MiB;
constexpr size_t WS_MODP = 1 * MiB;
constexpr size_t WS_MODF = 2 * MiB;
constexpr size_t WS_CS = 3 * MiB;
constexpr size_t WS_SSQ1 = 5 * MiB;
constexpr size_t WS_SSQ2 = 6 * MiB;
constexpr size_t WS_WUQ = 8 * MiB;
constexpr size_t WS_WUKV = 11 * MiB;
constexpr size_t WS_WCAT = 15 * MiB;
constexpr size_t WS_WOUT = 27 * MiB;
constexpr size_t WS_WPOOL = 35 * MiB;
constexpr size_t WS_WIN = 36 * MiB;
constexpr size_t WS_H = 73 * MiB;
constexpr size_t WS_ZC = 105 * MiB;
constexpr size_t WS_VPOOL = 121 * MiB;
constexpr size_t WS_GMLA = 137 * MiB;
constexpr size_t WS_GPOOL = 169 * MiB;
constexpr size_t WS_MG = 185 * MiB;
constexpr size_t WS_KR = 249 * MiB;
constexpr size_t WS_POOLED = 250 * MiB;
constexpr size_t WS_Q = 36 * MiB;
constexpr size_t WS_ACAT = 84 * MiB;
constexpr size_t WS_Y = 36 * MiB;
constexpr size_t WS_END = 266 * MiB;

typedef unsigned short bf16_t;
#define GAS __attribute__((address_space(1)))
#define LAS __attribute__((address_space(3)))
typedef unsigned v4u __attribute__((ext_vector_type(4)));
typedef unsigned v2u __attribute__((ext_vector_type(2)));
typedef float f32x4 __attribute__((ext_vector_type(4)));
typedef float f32x2 __attribute__((ext_vector_type(2)));
typedef short bf16x8 __attribute__((ext_vector_type(8)));
typedef GAS unsigned gu32;
#define RLX_AGENT __ATOMIC_RELAXED, __HIP_MEMORY_SCOPE_AGENT
#define LDS_WAIT() asm volatile("s_waitcnt lgkmcnt(0)" ::: "memory")
#define VM_WAIT() asm volatile("s_waitcnt vmcnt(0)" ::: "memory")

typedef float f32x2_t __attribute__((ext_vector_type(2))); typedef __bf16 bf16x2_t __attribute__((ext_vector_type(2)));
__device__ __forceinline__ unsigned cvt_pk_bf16(float lo, float hi) { f32x2_t v = {lo, hi}; bf16x2_t b = __builtin_convertvector(v, bf16x2_t); return __builtin_bit_cast(unsigned, b); }
__device__ __forceinline__ float bf_lo(unsigned w) { return __uint_as_float(w << 16); }
__device__ __forceinline__ float bf_hi(unsigned w) { return __uint_as_float(w & 0xffff0000u); }
__device__ __forceinline__ float silu_f(float v) { return v * __builtin_amdgcn_rcpf(1.f + __expf(-v)); }
__device__ __forceinline__ float sigm_f(float v) { return __builtin_amdgcn_rcpf(1.f + __expf(-v)); }
__device__ __forceinline__ int lane_id() { unsigned z; asm volatile("v_mov_b32 %0, 0" : "=v"(z)); return (int)__builtin_amdgcn_mbcnt_hi(~0u, __builtin_amdgcn_mbcnt_lo(~0u, z)); }
__device__ __forceinline__ float wave_sum(float v) {
#pragma unroll
    for (int o = 1; o < 64; o <<= 1) v += __shfl_xor(v, o);
    return v;
}

namespace pg8 {
constexpr int BM = 256, BK = 64, HALF = 128, HTB = HALF * BK * 2, STAGE_BYTES = 8 * HTB, NXCD = 8, WGM = 8;
__host__ __device__ __forceinline__ int lds_byte(int r, int c) { const int st = (r >> 4) * 2 + (c >> 5), rr = r & 15, cc = c & 31, ob = rr * 64 + cc * 2; return st * 1024 + (ob ^ (((ob >> 9) & 1) << 5)); }
__host__ __device__ __forceinline__ void stage_rc(int b, int& R, int& C) { const int st = b / 1024, sb = b % 1024, swz = sb ^ (((sb >> 9) & 1) << 5); R = (st >> 1) * 16 + swz / 64; C = (st & 1) * 32 + (swz % 64) / 2; }
__host__ __device__ __forceinline__ int perm32(int rho) { const int n = rho >> 4, i = rho & 15; return 8 * (i >> 2) + 4 * n + (i & 3); }

struct Unit { int pm, pn, ka; };
struct Gemm { const bf16_t* A; const bf16_t* Bt; int lda, ldb, M, N, K; };

struct StaticOrder {
    int nM, nN, nwg, G, c; int ka_split, ka_hi, ka_mul;
    __device__ void init(int M, int N, int G_, int c_) { nM = M / BM; nN = N / BM; nwg = nM * nN; G = G_; c = c_; ka_split = 1 << 30; ka_hi = 0; ka_mul = 0; }
    __device__ bool next(int i, Unit& u) const {
        const long L = (long)i * G + c; if (L >= nwg) return false;
        int wgid = (int)L; { const int q = nwg / NXCD, r = nwg % NXCD, xcd = wgid % NXCD, off = wgid / NXCD; wgid = (xcd < r ? xcd * (q + 1) : r * (q + 1) + (xcd - r) * q) + off; }
        const int nig = WGM * nN, gid = wgid / nig, fm = gid * WGM, gsz = (nM - fm) < WGM ? (nM - fm) : WGM;
        u.pm = fm + ((wgid % nig) % gsz); u.pn = (wgid % nig) / gsz;
        u.ka = (u.pn >= ka_split ? ka_hi : 0) + u.pn * ka_mul; return true;
    }
};

template <class Epi, class Sched, bool ALIGN_EPI>
__device__ __forceinline__ void gemm_phase(LAS unsigned char* lds, const Gemm g, const Sched& S, const Epi& E, const int wid) {
    const int lane = lane_id(), tid = wid * 64 + lane, wr = wid >> 2, wc = wid & 3, fr = lane & 15, fq = lane >> 4;
    const int K = g.K, nt = K / BK;
    unsigned voffA[2], voffB[2];
#pragma unroll
    for (int i = 0; i < 2; ++i) { int R, C; stage_rc(tid * 16 + i * 8192, R, C); const int Rb = Epi::PERM ? ((R & ~31) + perm32(R & 31)) : R;
        voffA[i] = (unsigned)(R * g.lda + C) * 2u; voffB[i] = (unsigned)(Rb * g.ldb + C) * 2u; }
    const size_t kstep = (size_t)(BK * 2);
    const size_t hstepA = (size_t)HALF * g.lda * 2, hstepB = (size_t)HALF * g.ldb * 2;
    const size_t tstepA = 2 * hstepA, tstepB = 2 * hstepB;
    const unsigned ldsw = (unsigned)wid * 1024u;
    const int aoff = lds_byte(wr * 64 + fr, fq * 8), boff = lds_byte(wc * 32 + fr, fq * 8);
#define PG8_SA(b, h) (((b) * 2 + (h)) * HTB)
#define PG8_SB(b, h) ((4 + (b) * 2 + (h)) * HTB)
#define PG8_STAGE(bufoff, gbase, voff) do { _Pragma("unroll") for (int _i = 0; _i < 2; ++_i) \
        __builtin_amdgcn_global_load_lds((const unsigned*)((const char*)(gbase) + (voff)[_i]), (LAS unsigned*)(lds + (bufoff) + ldsw + _i * 8192), 16, 0, 0); } while (0)
#define PG8_LDA(dst, b, h) do { _Pragma("unroll") for (int m = 0; m < 4; ++m) _Pragma("unroll") for (int k = 0; k < 2; ++k) dst[m][k] = *(const LAS bf16x8*)(lds + PG8_SA(b, h) + aoff + m * 2048 + k * 1024); } while (0)
#define PG8_LDB(dst, b, h) do { _Pragma("unroll") for (int n = 0; n < 2; ++n) _Pragma("unroll") for (int k = 0; k < 2; ++k) dst[n][k] = *(const LAS bf16x8*)(lds + PG8_SB(b, h) + boff + n * 2048 + k * 1024); } while (0)
#define PG8_MMA(ai, bj, At, Bt) do { __builtin_amdgcn_s_setprio(1); _Pragma("unroll") for (int m = 0; m < 4; ++m) _Pragma("unroll") for (int n = 0; n < 2; ++n) _Pragma("unroll") for (int k = 0; k < 2; ++k) \
        acc[ai][bj][m][n] = __builtin_amdgcn_mfma_f32_16x16x32_bf16(Bt[n][k], At[m][k], acc[ai][bj][m][n], 0, 0, 0); __builtin_amdgcn_s_setprio(0); } while (0)
#define PG8_WAIT_V(n) asm volatile("s_waitcnt vmcnt(" #n ")" ::: "memory")
#define PG8_WAIT_L(n) asm volatile("s_waitcnt lgkmcnt(" #n ")" ::: "memory")
#define PG8_BAR __builtin_amdgcn_s_barrier()
#define PG8_SCHED __builtin_amdgcn_sched_barrier(0)
    Unit cur, nxt; int ui = 0;
    if (!S.next(0, cur)) return;
    f32x4 acc[2][2][4][2];
#pragma unroll
    for (int a = 0; a < 2; ++a)
#pragma unroll
        for (int b = 0; b < 2; ++b)
#pragma unroll
            for (int m = 0; m < 4; ++m)
#pragma unroll
                for (int n = 0; n < 2; ++n) acc[a][b][m][n] = (f32x4){0.f, 0.f, 0.f, 0.f};
    bf16x8 At[4][2], B0[2][2], B1[2][2];
    const char* cA = (const char*)g.A + (size_t)cur.pm * tstepA + (size_t)cur.ka * 2; const char* cB = (const char*)g.Bt + (size_t)cur.pn * tstepB;
    PG8_STAGE(PG8_SB(0, 0), cB, voffB); PG8_STAGE(PG8_SB(0, 1), cB + hstepB, voffB); PG8_STAGE(PG8_SA(0, 0), cA, voffA); PG8_STAGE(PG8_SA(0, 1), cA + hstepA, voffA);
    if (wr == 1) PG8_BAR;
    PG8_WAIT_V(2); PG8_BAR;
    PG8_STAGE(PG8_SB(1, 0), cB + kstep, voffB); PG8_STAGE(PG8_SA(1, 0), cA + kstep, voffA); PG8_STAGE(PG8_SB(1, 1), cB + hstepB + kstep, voffB);
    PG8_WAIT_V(6); PG8_BAR;
    for (;;) {
        const bool has_next = S.next(ui + 1, nxt);
        const char* nA = has_next ? (const char*)g.A + (size_t)nxt.pm * tstepA + (size_t)nxt.ka * 2 : cA; const char* nB = has_next ? (const char*)g.Bt + (size_t)nxt.pn * tstepB : cB;
        for (int t = 0; t < nt; t += 2) {
            const bool last = (t == nt - 2);
            const char* a1 = cA + (size_t)(t + 1) * kstep;
            const char* a2 = last ? nA : cA + (size_t)(t + 2) * kstep; const char* b2 = last ? nB : cB + (size_t)(t + 2) * kstep;
            const char* a3 = a2 + kstep; const char* b3 = b2 + kstep;
            PG8_LDB(B0, 0, 0); PG8_LDB(B1, 0, 1); PG8_SCHED; PG8_LDA(At, 0, 0); PG8_STAGE(PG8_SA(1, 1), a1 + hstepA, voffA);
            PG8_WAIT_V(8); PG8_WAIT_L(0); PG8_BAR; PG8_MMA(0, 0, At, B0); PG8_MMA(0, 1, At, B1); PG8_BAR; PG8_SCHED;
            PG8_LDA(At, 0, 1); PG8_STAGE(PG8_SB(0, 0), b2, voffB); PG8_STAGE(PG8_SB(0, 1), b2 + hstepB, voffB); PG8_STAGE(PG8_SA(0, 0), a2, voffA);
            PG8_WAIT_V(8); PG8_WAIT_L(0); PG8_BAR; PG8_MMA(1, 0, At, B0); PG8_MMA(1, 1, At, B1); PG8_BAR; PG8_SCHED;
            PG8_LDB(B0, 1, 0); PG8_LDB(B1, 1, 1); PG8_SCHED; PG8_LDA(At, 1, 0); PG8_STAGE(PG8_SA(0, 1), a2 + hstepA, voffA);
            PG8_WAIT_V(8); PG8_WAIT_L(0); PG8_BAR; PG8_MMA(0, 0, At, B0); PG8_MMA(0, 1, At, B1); PG8_BAR; PG8_SCHED;
            PG8_LDA(At, 1, 1); PG8_STAGE(PG8_SB(1, 0), b3, voffB); PG8_STAGE(PG8_SB(1, 1), b3 + hstepB, voffB); PG8_STAGE(PG8_SA(1, 0), a3, voffA);
            PG8_WAIT_V(8); PG8_WAIT_L(0); PG8_BAR; PG8_MMA(1, 0, At, B0); PG8_MMA(1, 1, At, B1); PG8_BAR; PG8_SCHED;
        }
        if constexpr (ALIGN_EPI) { if (wr == 0) PG8_BAR; }
        E(acc, cur, wr, wc, fr, fq);
        if (!has_next) break;
#pragma unroll
        for (int a = 0; a < 2; ++a)
#pragma unroll
            for (int b = 0; b < 2; ++b)
#pragma unroll
                for (int m = 0; m < 4; ++m)
#pragma unroll
                    for (int n = 0; n < 2; ++n) acc[a][b][m][n] = (f32x4){0.f, 0.f, 0.f, 0.f};
        cur = nxt; cA = nA; cB = nB; ++ui;
        if constexpr (ALIGN_EPI) { if (wr == 1) PG8_BAR; }
    }
    PG8_WAIT_V(0);
    if constexpr (!ALIGN_EPI) { if (wr == 0) PG8_BAR; }
    PG8_BAR;
#undef PG8_SA
#undef PG8_SB
#undef PG8_STAGE
#undef PG8_LDA
#undef PG8_LDB
#undef PG8_MMA
#undef PG8_WAIT_V
#undef PG8_WAIT_L
#undef PG8_BAR
#undef PG8_SCHED
}

typedef f32x4 AccT[2][2][4][2];

struct EpiIn {
    static constexpr bool PERM = true;
    bf16_t *zc, *gmla, *vpool, *gpool, *mg, *kr; float* ssq1; const f32x2* cs;
    template <int ACT>
    __device__ __forceinline__ void body(const AccT& acc, bf16_t* base, int ld, int colt, int row0, int lc0, float* ssqp, int fq) const {
#pragma unroll
        for (int ai = 0; ai < 2; ++ai)
#pragma unroll
            for (int m = 0; m < 4; ++m) { const int row = row0 + ai * HALF + m * 16; bf16_t* rowp = base + (size_t)row * ld + colt + lc0; float s = 0.f;
#pragma unroll
                for (int bj = 0; bj < 2; ++bj) { f32x4 v0 = acc[ai][bj][m][0], v1 = acc[ai][bj][m][1];
                    if (ACT == 3) { s += (v0[0] * v0[0] + v0[1] * v0[1]) + (v0[2] * v0[2] + v0[3] * v0[3]) + (v1[0] * v1[0] + v1[1] * v1[1]) + (v1[2] * v1[2] + v1[3] * v1[3]); }
                    if (ACT == 1) {
#pragma unroll
                        for (int j = 0; j < 4; ++j) { v0[j] = silu_f(v0[j]); v1[j] = silu_f(v1[j]); } }
                    if (ACT == 2) {
#pragma unroll
                        for (int j = 0; j < 4; ++j) { v0[j] = sigm_f(v0[j]); v1[j] = sigm_f(v1[j]); } }
                    v4u w; w.x = cvt_pk_bf16(v0[0], v0[1]); w.y = cvt_pk_bf16(v0[2], v0[3]); w.z = cvt_pk_bf16(v1[0], v1[1]); w.w = cvt_pk_bf16(v1[2], v1[3]);
                    *(v4u*)(rowp + bj * HALF) = w; }
                if (ACT == 3) { s += __shfl_xor(s, 16); s += __shfl_xor(s, 32); if (fq == 0) ssqp[(size_t)row * 16] = s; }
            }
    }
    __device__ __forceinline__ void operator()(const AccT& acc, const Unit& u, int wr, int wc, int fr, int fq) const {
        const int pn = u.pn, row0 = u.pm * BM + wr * 64 + fr, lc0 = wc * 32 + 8 * fq;
        if (pn < 4) body<3>(acc, zc, 1024, pn * 256, row0, lc0, ssq1 + pn * 4 + wc, fq);
        else if (pn < 12) body<1>(acc, gmla, 2048, (pn - 4) * 256, row0, lc0, nullptr, fq);
        else if (pn < 16) body<0>(acc, vpool, 1024, (pn - 12) * 256, row0, lc0, nullptr, fq);
        else if (pn < 20) body<1>(acc, gpool, 1024, (pn - 16) * 256, row0, lc0, nullptr, fq);
        else if (pn < 36) body<2>(acc, mg, 4096, (pn - 20) * 256, row0, lc0, nullptr, fq);
        else if (wc < 2) {
            const int i0 = wc * 16 + 4 * fq;
#pragma unroll
            for (int ai = 0; ai < 2; ++ai)
#pragma unroll
                for (int m = 0; m < 4; ++m) { const int row = row0 + ai * HALF + m * 16;
                    const f32x4 c01 = *(const f32x4*)(cs + (size_t)row * 32 + i0), c23 = *(const f32x4*)(cs + (size_t)row * 32 + i0 + 2);
                    const f32x4 v0 = acc[ai][0][m][0], v1 = acc[ai][0][m][1];
                    const float o0 = v0[0] * c01[0] - v0[1] * c01[1], o1 = v0[1] * c01[0] + v0[0] * c01[1];
                    const float o2 = v0[2] * c01[2] - v0[3] * c01[3], o3 = v0[3] * c01[2] + v0[2] * c01[3];
                    const float o4 = v1[0] * c23[0] - v1[1] * c23[1], o5 = v1[1] * c23[0] + v1[0] * c23[1];
                    const float o6 = v1[2] * c23[2] - v1[3] * c23[3], o7 = v1[3] * c23[2] + v1[2] * c23[3];
                    v4u w; w.x = cvt_pk_bf16(o0, o1); w.y = cvt_pk_bf16(o2, o3); w.z = cvt_pk_bf16(o4, o5); w.w = cvt_pk_bf16(o6, o7);
                    *(v4u*)(kr + (size_t)row * 64 + lc0) = w; }
        }
    }
};

struct EpiQKV {
    static constexpr bool PERM = true;
    bf16_t *q, *kv; const float* ssq1; const f32x2* cs;
    __device__ __forceinline__ void operator()(const AccT& acc, const Unit& u, int wr, int wc, int fr, int fq) const {
        const bool isq = u.pn < 12; const int row0 = u.pm * BM + wr * 64 + fr, lc0 = wc * 32 + 8 * fq;
        const int colt = isq ? u.pn * 256 : (u.pn - 12) * 256; bf16_t* base = isq ? q : kv; const int ld = isq ? NQ : NKV;
#pragma unroll
        for (int ai = 0; ai < 2; ++ai)
#pragma unroll
            for (int m = 0; m < 4; ++m) { const int row = row0 + ai * HALF + m * 16;
                const f32x4 pa = *(const f32x4*)(ssq1 + (size_t)row * 16 + (isq ? 0 : 8)), pb = *(const f32x4*)(ssq1 + (size_t)row * 16 + (isq ? 4 : 12));
                const float ss = ((pa[0] + pa[1]) + (pa[2] + pa[3])) + ((pb[0] + pb[1]) + (pb[2] + pb[3]));
                float sc = 1.0f / sqrtf(ss * (1.0f / 512.0f) + EPS); if (isq) sc *= QSCALE_LOG2E;
#pragma unroll
                for (int bj = 0; bj < 2; ++bj) { const int col = colt + bj * HALF + lc0; f32x4 v0 = acc[ai][bj][m][0] * sc, v1 = acc[ai][bj][m][1] * sc;
                    if (isq) { const int d = col % QHD; if (d >= 128) { const int i0 = (d - 128) >> 1;
                        const f32x4 c01 = *(const f32x4*)(cs + (size_t)row * 32 + i0), c23 = *(const f32x4*)(cs + (size_t)row * 32 + i0 + 2);
                        const float o0 = v0[0] * c01[0] - v0[1] * c01[1], o1 = v0[1] * c01[0] + v0[0] * c01[1];
                        const float o2 = v0[2] * c01[2] - v0[3] * c01[3], o3 = v0[3] * c01[2] + v0[2] * c01[3];
                        const float o4 = v1[0] * c23[0] - v1[1] * c23[1], o5 = v1[1] * c23[0] + v1[0] * c23[1];
                        const float o6 = v1[2] * c23[2] - v1[3] * c23[3], o7 = v1[3] * c23[2] + v1[2] * c23[3];
                        v0 = (f32x4){o0, o1, o2, o3}; v1 = (f32x4){o4, o5, o6, o7}; } }
                    v4u w; w.x = cvt_pk_bf16(v0[0], v0[1]); w.y = cvt_pk_bf16(v0[2], v0[3]); w.z = cvt_pk_bf16(v1[0], v1[1]); w.w = cvt_pk_bf16(v1[2], v1[3]);
                    *(v4u*)(base + (size_t)row * ld + col) = w; }
            }
    }
};

struct EpiGateBf16 {
    static constexpr bool PERM = true;
    bf16_t* O; int ldo, ocol0; const bf16_t* G; int ldg, gcol0;
    __device__ __forceinline__ void operator()(const AccT& acc, const Unit& u, int wr, int wc, int fr, int fq) const {
        const int row0 = u.pm * BM + wr * 64 + fr, c0 = u.pn * 256 + wc * 32 + 8 * fq;
#pragma unroll
        for (int ai = 0; ai < 2; ++ai)
#pragma unroll
            for (int m = 0; m < 4; ++m) { const int row = row0 + ai * HALF + m * 16;
#pragma unroll
                for (int bj = 0; bj < 2; ++bj) { const int col = c0 + bj * HALF; const v4u gw = *(const v4u*)(G + (size_t)row * ldg + gcol0 + col);
                    const f32x4 v0 = acc[ai][bj][m][0], v1 = acc[ai][bj][m][1];
                    v4u w; w.x = cvt_pk_bf16(v0[0] * bf_lo(gw.x), v0[1] * bf_hi(gw.x)); w.y = cvt_pk_bf16(v0[2] * bf_lo(gw.y), v0[3] * bf_hi(gw.y));
                    w.z = cvt_pk_bf16(v1[0] * bf_lo(gw.z), v1[1] * bf_hi(gw.z)); w.w = cvt_pk_bf16(v1[2] * bf_lo(gw.w), v1[3] * bf_hi(gw.w));
                    *(v4u*)(O + (size_t)row * ldo + ocol0 + col) = w; }
            }
    }
};
struct EpiGateF32 {
    static constexpr bool PERM = true;
    float* T; const bf16_t* G; int ldg, gcol0;
    __device__ __forceinline__ void operator()(const AccT& acc, const Unit& u, int wr, int wc, int fr, int fq) const {
        const int row0 = u.pm * BM + wr * 64 + fr, c0 = u.pn * 256 + wc * 32 + 8 * fq;
#pragma unroll
        for (int ai = 0; ai < 2; ++ai)
#pragma unroll
            for (int m = 0; m < 4; ++m) { const int row = row0 + ai * HALF + m * 16;
#pragma unroll
                for (int bj = 0; bj < 2; ++bj) { const int col = c0 + bj * HALF; const v4u gw = *(const v4u*)(G + (size_t)row * ldg + gcol0 + col);
                    const f32x4 v0 = acc[ai][bj][m][0], v1 = acc[ai][bj][m][1];
                    f32x4 t0 = {v0[0] * bf_lo(gw.x), v0[1] * bf_hi(gw.x), v0[2] * bf_lo(gw.y), v0[3] * bf_hi(gw.y)};
                    f32x4 t1 = {v1[0] * bf_lo(gw.z), v1[1] * bf_hi(gw.z), v1[2] * bf_lo(gw.w), v1[3] * bf_hi(gw.w)};
                    float* tp = T + (size_t)row * DM + col; *(f32x4*)tp = t0; *(f32x4*)(tp + 4) = t1; }
            }
    }
};
struct EpiGateAddBf16 {
    static constexpr bool PERM = true;
    bf16_t* Y; const float* T; const bf16_t* G; int ldg, gcol0;
    __device__ __forceinline__ void operator()(const AccT& acc, const Unit& u, int wr, int wc, int fr, int fq) const {
        const int row0 = u.pm * BM + wr * 64 + fr, c0 = u.pn * 256 + wc * 32 + 8 * fq;
#pragma unroll
        for (int ai = 0; ai < 2; ++ai)
#pragma unroll
            for (int m = 0; m < 4; ++m) { const int row = row0 + ai * HALF + m * 16;
#pragma unroll
                for (int bj = 0; bj < 2; ++bj) { const int col = c0 + bj * HALF; const v4u gw = *(const v4u*)(G + (size_t)row * ldg + gcol0 + col);
                    const float* tp = T + (size_t)row * DM + col; const f32x4 t0 = *(const f32x4*)tp, t1 = *(const f32x4*)(tp + 4);
                    const f32x4 v0 = acc[ai][bj][m][0], v1 = acc[ai][bj][m][1];
                    v4u w; w.x = cvt_pk_bf16(t0[0] + v0[0] * bf_lo(gw.x), t0[1] + v0[1] * bf_hi(gw.x)); w.y = cvt_pk_bf16(t0[2] + v0[2] * bf_lo(gw.y), t0[3] + v0[3] * bf_hi(gw.y));
                    w.z = cvt_pk_bf16(t1[0] + v1[0] * bf_lo(gw.z), t1[1] + v1[1] * bf_hi(gw.z)); w.w = cvt_pk_bf16(t1[2] + v1[2] * bf_lo(gw.w), t1[3] + v1[3] * bf_hi(gw.w));
                    *(v4u*)(Y + (size_t)row * DM + col) = w; }
            }
    }
};
struct EpiOut {
    static constexpr bool PERM = false;
    const float* x; float* out; const float* modf; float* ssq2;
    __device__ __forceinline__ void operator()(const AccT& acc, const Unit& u, int wr, int wc, int fr, int fq) const {
        const int row0 = u.pm * BM + wr * 64 + fr, col0 = u.pn * BM + wc * 32 + 4 * fq; const int b = u.pm >> 4;
        f32x4 gv[2][2];
#pragma unroll
        for (int bj = 0; bj < 2; ++bj)
#pragma unroll
            for (int n = 0; n < 2; ++n) gv[bj][n] = *(const f32x4*)(modf + (size_t)b * NMOD + 2 * DM + col0 + bj * HALF + n * 16);
#pragma unroll
        for (int ai = 0; ai < 2; ++ai)
#pragma unroll
            for (int m = 0; m < 4; ++m) { const int row = row0 + ai * HALF + m * 16; const size_t off = (size_t)row * DM + col0; float s = 0.f;
#pragma unroll
                for (int bj = 0; bj < 2; ++bj)
#pragma unroll
                    for (int n = 0; n < 2; ++n) { const f32x4 xv = *(const f32x4*)(x + off + bj * HALF + n * 16); const f32x4 o = xv + gv[bj][n] * acc[ai][bj][m][n];
                        s += (o[0] * o[0] + o[1] * o[1]) + (o[2] * o[2] + o[3] * o[3]); *(f32x4*)(out + off + bj * HALF + n * 16) = o; }
                s += __shfl_xor(s, 16); s += __shfl_xor(s, 32); if (fq == 0) ssq2[(size_t)row * 32 + u.pn * 4 + wc] = s;
            }
    }
};
}

namespace att {
using bf16x8 = __attribute__((ext_vector_type(8))) short;
using s16x4 = __attribute__((ext_vector_type(4))) short;
using f32x16 = __attribute__((ext_vector_type(16))) float;
constexpr int NW = 8, QBLK = 32, KVBLK = 64;
constexpr int LDQ = NQ, LDK = NKV, LDR = 64, LDO = 3072, LDG = 2048;
constexpr int SHM_V = 16384, SHM_K = 24576;
constexpr int OFF_V = 0, OFF_K = 2 * SHM_V, OFF_WS = OFF_K + 2 * SHM_K, OFF_QR = OFF_WS + NW * 64 * 4, ATT_LDS = OFF_QR + NW * 4096;
constexpr float THR2 = 8.f * 1.4426950408889634f;
#define SBAR() __builtin_amdgcn_sched_barrier(0)
__device__ __forceinline__ int crow(int r, int hi) { return (r & 3) + 8 * (r >> 2) + 4 * hi; }
__device__ __forceinline__ unsigned cvtpk(float lo, float hi) { return cvt_pk_bf16(lo, hi); }

__device__ __forceinline__ void partialSM(f32x16& p0, f32x16& p1, float& m_reg, float& alpha) {
    float pmax = p0[0];
#pragma unroll
    for (int r = 1; r < 16; ++r) pmax = fmaxf(pmax, p0[r]);
#pragma unroll
    for (int r = 0; r < 16; ++r) pmax = fmaxf(pmax, p1[r]);
    { auto rr = __builtin_amdgcn_permlane32_swap(__float_as_uint(pmax), __float_as_uint(pmax), false, false);
      pmax = fmaxf(__uint_as_float(rr[0]), __uint_as_float(rr[1])); }
    float mn;
    if (__builtin_expect(__all(pmax - m_reg <= THR2), 1)) { mn = m_reg; alpha = 1.f; }
    else { mn = fmaxf(m_reg, pmax); alpha = __builtin_amdgcn_exp2f(m_reg - mn); m_reg = mn; }
#pragma unroll
    for (int r = 0; r < 16; ++r) p0[r] = p0[r] - mn;
#pragma unroll
    for (int r = 0; r < 16; ++r) p1[r] = p1[r] - mn;
#pragma unroll
    for (int r = 0; r < 16; ++r) p0[r] = __builtin_amdgcn_exp2f(p0[r]);
}
__device__ __forceinline__ void finishSM(f32x16& p0, f32x16& p1, float alpha, float& l_reg, bf16x8& pa0, bf16x8& pa1, bf16x8& pa2, bf16x8& pa3) {
#pragma unroll
    for (int r = 0; r < 16; ++r) p1[r] = __builtin_amdgcn_exp2f(p1[r]);
    float ps = 0;
#pragma unroll
    for (int r = 0; r < 16; ++r) ps += p0[r];
#pragma unroll
    for (int r = 0; r < 16; ++r) ps += p1[r];
    { auto rr = __builtin_amdgcn_permlane32_swap(__float_as_uint(ps), __float_as_uint(ps), false, false);
      ps = __uint_as_float(rr[0]) + __uint_as_float(rr[1]); }
    l_reg = l_reg * alpha + ps;
#define PK4(P, BASE, OUT) do { unsigned a0 = cvtpk(P[BASE + 0], P[BASE + 1]), a1 = cvtpk(P[BASE + 2], P[BASE + 3]);   \
    unsigned b0 = cvtpk(P[BASE + 4], P[BASE + 5]), b1 = cvtpk(P[BASE + 6], P[BASE + 7]);                              \
    auto r0 = __builtin_amdgcn_permlane32_swap(a0, b0, false, false); auto r1 = __builtin_amdgcn_permlane32_swap(a1, b1, false, false); \
    v4u w = {r0[0], r1[0], r0[1], r1[1]}; OUT = *reinterpret_cast<bf16x8*>(&w); } while (0)
    PK4(p0, 0, pa0); PK4(p0, 8, pa1); PK4(p1, 0, pa2); PK4(p1, 8, pa3);
#undef PK4
}
__device__ __forceinline__ void qkt(f32x16& p0, f32x16& p1, const char* kb, const bf16x8* qr, const char* qrl) {
    p0 = f32x16{}; p1 = f32x16{};
#pragma unroll
    for (int d0 = 0; d0 < 8; ++d0) {
        const bf16x8 b0 = *reinterpret_cast<const bf16x8*>(kb + d0 * 2048);
        const bf16x8 b1 = *reinterpret_cast<const bf16x8*>(kb + d0 * 2048 + 512);
        p0 = __builtin_amdgcn_mfma_f32_32x32x16_bf16(b0, qr[d0], p0, 0, 0, 0);
        p1 = __builtin_amdgcn_mfma_f32_32x32x16_bf16(b1, qr[d0], p1, 0, 0, 0); }
#pragma unroll
    for (int d0 = 8; d0 < 12; ++d0) {
        const bf16x8 b0 = *reinterpret_cast<const bf16x8*>(kb + d0 * 2048);
        const bf16x8 b1 = *reinterpret_cast<const bf16x8*>(kb + d0 * 2048 + 512);
        const bf16x8 qf = *reinterpret_cast<const bf16x8*>(qrl + (d0 - 8) * 1024);
        p0 = __builtin_amdgcn_mfma_f32_32x32x16_bf16(b0, qf, p0, 0, 0, 0);
        p1 = __builtin_amdgcn_mfma_f32_32x32x16_bf16(b1, qf, p1, 0, 0, 0); }
}
__device__ __forceinline__ int v_st(int k, int c) { const int kk = (k & ~0xC) | ((k & 4) << 1) | ((k & 8) >> 1); return ((kk >> 3) * 4 + (c >> 5)) * 512 + ((kk & 7) * 32 + (c & 31)) * 2; }
__device__ __forceinline__ int v_rd_base(int lane) { return ((lane & 3) << 3) | (((lane >> 2) & 3) << 6) | (((lane >> 4) & 1) << 5) | (((lane >> 5) & 1) << 8); }
constexpr int v_rd_off(int d0, int ks, int half) { return d0 * 512 + ks * 4096 + half * 2048; }
template <int OFF> __device__ __forceinline__ s16x4 tr_read(int vb) {
    s16x4 r; asm volatile("ds_read_b64_tr_b16 %0, %1 offset:%2" : "=&v"(r) : "v"(vb), "i"(OFF) : "memory"); return r;
}
template <int D0> __device__ __forceinline__ void pv_one(f32x16& od, int vb, bf16x8 pa0, bf16x8 pa1, bf16x8 pa2, bf16x8 pa3) {
    const s16x4 l0 = tr_read<v_rd_off(D0, 0, 0)>(vb), h0 = tr_read<v_rd_off(D0, 0, 1)>(vb), l1 = tr_read<v_rd_off(D0, 1, 0)>(vb), h1 = tr_read<v_rd_off(D0, 1, 1)>(vb);
    const s16x4 l2 = tr_read<v_rd_off(D0, 2, 0)>(vb), h2 = tr_read<v_rd_off(D0, 2, 1)>(vb), l3 = tr_read<v_rd_off(D0, 3, 0)>(vb), h3 = tr_read<v_rd_off(D0, 3, 1)>(vb);
    asm volatile("s_waitcnt lgkmcnt(0)" ::: "memory"); SBAR();
#define PK(L, H) (bf16x8){L[0], L[1], L[2], L[3], H[0], H[1], H[2], H[3]}
    od = __builtin_amdgcn_mfma_f32_32x32x16_bf16(pa0, PK(l0, h0), od, 0, 0, 0);
    od = __builtin_amdgcn_mfma_f32_32x32x16_bf16(pa1, PK(l1, h1), od, 0, 0, 0);
    od = __builtin_amdgcn_mfma_f32_32x32x16_bf16(pa2, PK(l2, h2), od, 0, 0, 0);
    od = __builtin_amdgcn_mfma_f32_32x32x16_bf16(pa3, PK(l3, h3), od, 0, 0, 0);
#undef PK
}
__device__ __forceinline__ void pv_d0(f32x16* o, int vb, bf16x8 pa0, bf16x8 pa1, bf16x8 pa2, bf16x8 pa3) {
    pv_one<0>(o[0], vb, pa0, pa1, pa2, pa3); pv_one<1>(o[1], vb, pa0, pa1, pa2, pa3); pv_one<2>(o[2], vb, pa0, pa1, pa2, pa3); pv_one<3>(o[3], vb, pa0, pa1, pa2, pa3);
}

__device__ __forceinline__ void attn_unit(int b, int h, int qb, const bf16_t* __restrict__ Q, const bf16_t* __restrict__ KV, const bf16_t* __restrict__ KR,
                                          const bf16_t* __restrict__ G, bf16_t* __restrict__ O, char* lds, const int wid) {
    const int lane = lane_id(), tid = wid * 64 + lane, r32 = lane & 31, hi = lane >> 5;
    char* V_lds = lds + OFF_V; char* K_lds = lds + OFF_K;
    float* ws = (float*)(lds + OFF_WS) + wid * 64; float* li_l = ws; float* al_l = ws + 32;
    const long rowbase = (long)b * SEQ; const int q0 = qb * 256;
    float m_reg = -1e30f, l_reg = 0; f32x16 o[4] = {}; bf16x8 qr[8];
    char* qrl = lds + OFF_QR + wid * 4096 + hi * 512 + r32 * 16;
    { const bf16_t* Qw = Q + (rowbase + q0 + wid * QBLK + r32) * LDQ + h * QHD + hi * 8;
#pragma unroll
      for (int d0 = 0; d0 < 8; ++d0) qr[d0] = *reinterpret_cast<const bf16x8*>(Qw + d0 * 16);
#pragma unroll
      for (int d0 = 8; d0 < 12; ++d0) *reinterpret_cast<bf16x8*>(qrl + (d0 - 8) * 1024) = *reinterpret_cast<const bf16x8*>(Qw + d0 * 16); }
    const char* Kh = (const char*)(KV + rowbase * LDK + h * KVHD); const char* Rh = (const char*)(KR + rowbase * LDR);
    const int krow = wid * 8 + (lane & 7), kch = lane >> 3, sr = tid >> 4, sc = (tid & 15) * 8;
    const unsigned koff = (unsigned)(krow * LDK + kch * 8) * 2u, roff = (unsigned)(krow * LDR + kch * 8) * 2u, voff = (unsigned)(sr * LDK + 128 + sc) * 2u;
    const int kw = kch * 1024 + krow * 16, vst0 = v_st(sr, sc), vst1 = v_st(32 + sr, sc);
    const int vb0 = (int)(uintptr_t)V_lds + v_rd_base(lane);
    const char* kb0 = K_lds + hi * 1024 + r32 * 16;
    bf16x8 vs0, vs1, ks0, ks1, rs0;
#define SLOAD(k0) do { const char* kt_ = Kh + (size_t)(k0) * (LDK * 2); const char* rt_ = Rh + (size_t)(k0) * (LDR * 2); \
    vs0 = *reinterpret_cast<const bf16x8*>(kt_ + voff); vs1 = *reinterpret_cast<const bf16x8*>(kt_ + (size_t)32 * LDK * 2 + voff); \
    ks0 = *reinterpret_cast<const bf16x8*>(kt_ + koff); ks1 = *reinterpret_cast<const bf16x8*>(kt_ + koff + 128); \
    rs0 = *reinterpret_cast<const bf16x8*>(rt_ + roff); } while (0)
#define SWRITE(bb) do { *(bf16x8*)(V_lds + (bb) * SHM_V + vst0) = vs0; *(bf16x8*)(V_lds + (bb) * SHM_V + vst1) = vs1; \
    *(bf16x8*)(K_lds + (bb) * SHM_K + kw) = ks0; *(bf16x8*)(K_lds + (bb) * SHM_K + 8192 + kw) = ks1; \
    *(bf16x8*)(K_lds + (bb) * SHM_K + 16384 + kw) = rs0; } while (0)
#define SWAIT() asm volatile("s_waitcnt vmcnt(0)" ::: "memory")
#define RESC(a) do { if (__any((a) < 1.f)) { if (hi == 0) al_l[r32] = (a); asm volatile("s_waitcnt lgkmcnt(0)" ::: "memory"); \
    _Pragma("unroll") for (int d = 0; d < 4; ++d) _Pragma("unroll") for (int r = 0; r < 16; ++r) o[d][r] *= al_l[crow(r, hi)]; } } while (0)
    f32x16 pA0, pA1, pB0, pB1; float alA, alB; bf16x8 pa0, pa1, pa2, pa3; constexpr int NT = SEQ / KVBLK;
    SLOAD(0); SWAIT(); SWRITE(0); __syncthreads();
    qkt(pA0, pA1, kb0, qr, qrl); partialSM(pA0, pA1, m_reg, alA);
    SLOAD(KVBLK);
    SWAIT(); SWRITE(1); __syncthreads();
    for (int j = 1; j + 1 < NT; j += 2) {
        SBAR(); qkt(pB0, pB1, kb0 + SHM_K, qr, qrl);
        finishSM(pA0, pA1, alA, l_reg, pa0, pa1, pa2, pa3); SBAR();
        SLOAD((j + 1) * KVBLK); SBAR();
        pv_d0(o, vb0, pa0, pa1, pa2, pa3); partialSM(pB0, pB1, m_reg, alB);
        __syncthreads(); SWAIT(); SWRITE(0);
        RESC(alB); __syncthreads();
        SBAR(); qkt(pA0, pA1, kb0, qr, qrl);
        finishSM(pB0, pB1, alB, l_reg, pa0, pa1, pa2, pa3); SBAR();
        SLOAD((j + 2) * KVBLK); SBAR();
        pv_d0(o, vb0 + SHM_V, pa0, pa1, pa2, pa3); partialSM(pA0, pA1, m_reg, alA);
        __syncthreads(); SWAIT(); SWRITE(1);
        RESC(alA); __syncthreads();
    }
    SBAR(); qkt(pB0, pB1, kb0 + SHM_K, qr, qrl);
    finishSM(pA0, pA1, alA, l_reg, pa0, pa1, pa2, pa3); SBAR();
    pv_d0(o, vb0, pa0, pa1, pa2, pa3); partialSM(pB0, pB1, m_reg, alB);
    __syncthreads(); RESC(alB);
    finishSM(pB0, pB1, alB, l_reg, pa0, pa1, pa2, pa3); SBAR();
    pv_d0(o, vb0 + SHM_V, pa0, pa1, pa2, pa3);
    if (hi == 0) li_l[r32] = l_reg; asm volatile("s_waitcnt lgkmcnt(0)" ::: "memory");
    float rli[16];
#pragma unroll
    for (int r = 0; r < 16; ++r) rli[r] = __builtin_amdgcn_rcpf(li_l[crow(r, hi)]);
    __syncthreads();
    unsigned short* stg = (unsigned short*)(lds + wid * 8192);
#pragma unroll
    for (int r = 0; r < 16; ++r) { const int orow = crow(r, hi);
#pragma unroll
        for (int d0 = 0; d0 < 4; ++d0) { const unsigned w = cvtpk(o[d0][r] * rli[r], 0.f); stg[orow * 128 + d0 * 32 + r32] = (unsigned short)(w & 0xffffu); } }
    asm volatile("s_waitcnt lgkmcnt(0)" ::: "memory");
    const long grow0 = rowbase + q0 + wid * QBLK; const int lane2 = lane_id();
#pragma unroll
    for (int i = 0; i < 8; ++i) { const int row = i * 4 + (lane2 >> 4), ch = lane2 & 15;
        const v4u v = *(const v4u*)(stg + row * 128 + ch * 8); const v4u gw = *(const v4u*)(G + (grow0 + row) * LDG + h * 128 + ch * 8);
        v4u w; w.x = cvtpk(bf_lo(v.x) * bf_lo(gw.x), bf_hi(v.x) * bf_hi(gw.x)); w.y = cvtpk(bf_lo(v.y) * bf_lo(gw.y), bf_hi(v.y) * bf_hi(gw.y));
        w.z = cvtpk(bf_lo(v.z) * bf_lo(gw.z), bf_hi(v.z) * bf_hi(gw.z)); w.w = cvtpk(bf_lo(v.w) * bf_lo(gw.w), bf_hi(v.w) * bf_hi(gw.w));
        *(v4u*)(O + (grow0 + row) * LDO + h * 128 + ch * 8) = w; }
    asm volatile("s_waitcnt lgkmcnt(0)" ::: "memory");
    __syncthreads();
#undef SLOAD
#undef SWRITE
#undef SWAIT
#undef RESC
}
#undef SBAR
}

constexpr int NWAVES = 8;
constexpr int N_PHASES = 8;
constexpr int CW_TMO = 0, CW_BAR = 4096;
constexpr int RING_BYTES = 131072, LDSCTL_OFF = RING_BYTES, MISC_OFF = LDSCTL_OFF + 320, LDS_BYTES = 147456;

#define XB_TMO      128
#define XB_XCNT(j)  (256  + 64 * (j))
#define XB_XSUB(j)  (1280 + 64 * (j))
#define XB_XGEN(j)  (2304 + 64 * (j))
#define XB_TOP      3328
#define XB_TOPGEN   3392
#define XCD_BAR_WORDS 3456
#define XB_SPIN_CAP (1u << 22)
__device__ __forceinline__ unsigned xb_ld(unsigned* p)              { return __hip_atomic_load(p, __ATOMIC_RELAXED, __HIP_MEMORY_SCOPE_AGENT); }
__device__ __forceinline__ unsigned xb_add(unsigned* p, unsigned v) { return __hip_atomic_fetch_add(p, v, __ATOMIC_RELAXED, __HIP_MEMORY_SCOPE_AGENT); }
__device__ __forceinline__ unsigned xb_xcc_id() { return (unsigned)__builtin_amdgcn_s_getreg((3 << 11) | 20) & 0xFu; }
#define XB_SPIN(cond, bar) do { unsigned _sp = 0; while (cond) { __builtin_amdgcn_s_sleep(1); \
    if ((++_sp & 255u) == 0u) { if (xb_ld(&(bar)[XB_TMO])) break; if (_sp > XB_SPIN_CAP) { atomicAdd(&(bar)[XB_TMO], 1u); break; } } } } while (0)
struct XcdBarrier { unsigned* bar; unsigned x; volatile LAS unsigned* st; };
__device__ __forceinline__ XcdBarrier xcd_barrier_post(unsigned* bar, volatile LAS unsigned* st, int wave) {
    XcdBarrier b; b.bar = bar; b.x = xb_xcc_id(); b.st = st;
    if (wave == 0 && lane_id() == 0) (void)xb_add(&bar[XB_XCNT(b.x)], 1u);
    return b;
}
__device__ __forceinline__ void xcd_barrier_complete(unsigned* bar, unsigned x, unsigned& nloc, unsigned& nx) {
    const unsigned G = gridDim.x * gridDim.y * gridDim.z;
    unsigned sum, cnt, mine, sp = 0u;
    for (;;) {
        sum = 0u; cnt = 0u; mine = 0u;
#pragma unroll
        for (unsigned j = 0; j < 16; ++j) { const unsigned c = xb_ld(&bar[XB_XCNT(j)]); sum += c; cnt += (c > 0u) ? 1u : 0u; mine = (j == x) ? c : mine; }
        if (sum == G) break;
        __builtin_amdgcn_s_sleep(1);
        if ((++sp & 255u) == 0u) { if (xb_ld(&bar[XB_TMO])) break; if (sp > XB_SPIN_CAP) { atomicAdd(&bar[XB_TMO], 1u); break; } }
    }
    nloc = mine > 0u ? mine : 1u; nx = cnt > 0u ? cnt : 1u;
}
__device__ __forceinline__ void xcd_barrier(const XcdBarrier& b, int wave) {
    asm volatile("s_waitcnt vmcnt(0)" ::: "memory");
    __syncthreads();
    if (wave == 0 && lane_id() == 0) {
        unsigned* bar = b.bar;
        __builtin_amdgcn_s_waitcnt(0);
        unsigned nloc = b.st[0], nx = b.st[1];
        if (nloc == 0u) { xcd_barrier_complete(bar, b.x, nloc, nx); b.st[0] = nloc; b.st[1] = nx; }
        const unsigned old = xb_add(&bar[XB_XSUB(b.x)], 1u);
        const unsigned gen = old / nloc;
        if (old + 1u == (gen + 1u) * nloc) {
            __builtin_amdgcn_fence(__ATOMIC_RELEASE, "agent");
            asm volatile("s_waitcnt vmcnt(0)" ::: "memory");
            const unsigned og = xb_add(&bar[XB_TOP], 1u);
            const unsigned tg = og / nx;
            if (og + 1u == (tg + 1u) * nx) xb_add(&bar[XB_TOPGEN], 1u);
            else XB_SPIN(xb_ld(&bar[XB_TOPGEN]) == tg, bar);
            __builtin_amdgcn_fence(__ATOMIC_ACQUIRE, "agent");
            xb_add(&bar[XB_XGEN(b.x)], 1u);
            asm volatile("s_waitcnt vmcnt(0)" ::: "memory");
        } else {
            XB_SPIN(xb_ld(&bar[XB_XGEN(b.x)]) == gen, bar);
            __builtin_amdgcn_fence(__ATOMIC_ACQUIRE, "agent");
            asm volatile("s_waitcnt vmcnt(0)" ::: "memory");
        }
    }
    __syncthreads();
}

struct Args {
    const float *x, *c; const int* pos; const float *ada_w, *ada_b, *norm_g, *w_in, *q_norm_g, *w_uq, *kv_norm_g, *w_ukv, *w_o_mla, *pool_w, *pool_scale, *w_o_pool, *w_out, *final_g;
    float* out; unsigned char* ws; int ph_lo, ph_hi, li, pad;
};

__device__ __forceinline__ int srccol(int kind, int n) {
    if (kind == 0) return n;
    if (kind == 1) { if (n < 1024) return n; if (n < 9216) return n + 64; if (n < 9280) { const int i = (n - 9216) >> 1, j = (n - 9216) & 1; return 1024 + i + 32 * j; } return -1; }
    if (kind == 2) { const int h = n / QHD, d = n % QHD; if (d < 128) return n; const int i = (d - 128) >> 1, j = (d - 128) & 1; return h * QHD + 128 + i + 32 * j; }
      { const int g = n >> 8, d = n & 255; return g * 65536 + d; }
}
__device__ __forceinline__ void tr_item(const float* W, int ldw, bf16_t* WT, int ldt, int dcol, int nblk, int kind, const float* kscale, const float* nscale,
                                        LAS float* scr, int item, int lane) {
    const int kb = item / nblk, nb = item % nblk, k0 = 64 * kb, n0 = 32 * nb;
    const int sc_ = srccol(kind, n0 + (lane & 31)); const float ns = (nscale && sc_ >= 0) ? nscale[n0 + (lane & 31)] : 1.f;
#pragma unroll 8
    for (int i = 0; i < 32; ++i) { const int kk = 2 * i + (lane >> 5); float v = 0.f;
        if (sc_ >= 0) { v = W[(size_t)(k0 + kk) * ldw + sc_] * ns; if (kscale) v *= kscale[k0 + kk]; }
        scr[kk * 33 + (lane & 31)] = v; }
    LDS_WAIT(); asm volatile("" ::: "memory");
    const int c = lane & 7;
#pragma unroll
    for (int j = 0; j < 4; ++j) { const int n = (lane >> 3) + 8 * j; const LAS float* s = scr + (8 * c) * 33 + n;
        v4u o; o.x = cvt_pk_bf16(s[0 * 33], s[1 * 33]); o.y = cvt_pk_bf16(s[2 * 33], s[3 * 33]); o.z = cvt_pk_bf16(s[4 * 33], s[5 * 33]); o.w = cvt_pk_bf16(s[6 * 33], s[7 * 33]);
        *(GAS v4u*)(WT + (size_t)(n0 + n) * ldt + dcol + k0 + 8 * c) = o; }
    LDS_WAIT(); asm volatile("" ::: "memory");
}
__device__ __forceinline__ void sincos_acc(float af, float& sn, float& cs) {
    const double a = (double)af; const double n = rint(a * 0.63661977236758134308);
    double r = fma(-n, 1.57079632679489655800, a); r = fma(-n, 6.12323399573676603587e-17, r);
    const double r2 = r * r;
    double ps = 1.0 / 6227020800.0; ps = fma(ps, r2, -1.0 / 39916800.0); ps = fma(ps, r2, 1.0 / 362880.0); ps = fma(ps, r2, -1.0 / 5040.0); ps = fma(ps, r2, 1.0 / 120.0); ps = fma(ps, r2, -1.0 / 6.0); ps = fma(ps, r2, 1.0);
    const double s = r * ps;
    double pc = -1.0 / 87178291200.0; pc = fma(pc, r2, 1.0 / 479001600.0); pc = fma(pc, r2, -1.0 / 3628800.0); pc = fma(pc, r2, 1.0 / 40320.0); pc = fma(pc, r2, -1.0 / 720.0); pc = fma(pc, r2, 1.0 / 24.0); pc = fma(pc, r2, -0.5); pc = fma(pc, r2, 1.0);
    const int q = ((int)n) & 3;
    const double ss = (q == 0) ? s : (q == 1) ? pc : (q == 2) ? -s : -pc;
    const double cc = (q == 0) ? pc : (q == 1) ? -s : (q == 2) ? -pc : s;
    sn = (float)ss; cs = (float)cc;
}

__global__ void __launch_bounds__(NWAVES * 64, 2) mk_fwd(Args args) {
    extern __shared__ __attribute__((aligned(16))) unsigned char lds[];
    LAS unsigned char* L = (LAS unsigned char*)lds;
    volatile LAS unsigned* MISC = (volatile LAS unsigned*)(L + MISC_OFF);
    const int wave = __builtin_amdgcn_readfirstlane(threadIdx.x >> 6);
    const int G = gridDim.x; const int bx = blockIdx.x; const int vcu = (G % 8 == 0) ? (bx % 8) * (G / 8) + bx / 8 : bx;
    unsigned char* ws = args.ws;
    gu32* ctl = (gu32*)(ws + WS_CTL);
    { const int tid = wave * 64 + lane_id();
      for (int u = tid; u < (LDS_BYTES - LDSCTL_OFF) / 4; u += NWAVES * 64) ((LAS unsigned*)(L + LDSCTL_OFF))[u] = 0u; }
    __syncthreads();
    XcdBarrier bar; bar.bar = (unsigned*)(ctl + CW_BAR); bar.x = 0; bar.st = nullptr;
    const int lo = args.ph_lo, hi = args.ph_hi;
    if (hi - lo > 1) bar = xcd_barrier_post((unsigned*)(ctl + CW_BAR), MISC + 8, wave);
#ifndef PH_MASK
#define PH_MASK 0xff
#endif
#define IN(k) (((PH_MASK >> (k)) & 1) && lo <= (k) && (k) < hi)
#define BOTH(k) (IN(k) && IN((k) + 1))
#define GRID_BAR() xcd_barrier(bar, wave)

    float* modp = (float*)(ws + WS_MODP); float* modf = (float*)(ws + WS_MODF); f32x2* cstab = (f32x2*)(ws + WS_CS);
    float* ssq1 = (float*)(ws + WS_SSQ1); float* ssq2 = (float*)(ws + WS_SSQ2);
    bf16_t* Wuq = (bf16_t*)(ws + WS_WUQ); bf16_t* Wukv = (bf16_t*)(ws + WS_WUKV); bf16_t* Wcat = (bf16_t*)(ws + WS_WCAT); bf16_t* Wout = (bf16_t*)(ws + WS_WOUT);
    bf16_t* Wpool = (bf16_t*)(ws + WS_WPOOL); bf16_t* Win = (bf16_t*)(ws + WS_WIN); bf16_t* Hb = (bf16_t*)(ws + WS_H);
    bf16_t* ZC = (bf16_t*)(ws + WS_ZC); bf16_t* VPOOL = (bf16_t*)(ws + WS_VPOOL); bf16_t* GMLA = (bf16_t*)(ws + WS_GMLA); bf16_t* GPOOL = (bf16_t*)(ws + WS_GPOOL);
    bf16_t* MG = (bf16_t*)(ws + WS_MG); bf16_t* KRb = (bf16_t*)(ws + WS_KR); bf16_t* POOLED = (bf16_t*)(ws + WS_POOLED);
    bf16_t* Qb = (bf16_t*)(ws + WS_Q); bf16_t* ACAT = (bf16_t*)(ws + WS_ACAT); bf16_t* Yb = (bf16_t*)(ws + WS_Y);
    bf16_t* KVb = (bf16_t*)args.out; float* Tb = args.out;

    if (IN(0)) {
        const int lane = lane_id();
        LAS float* scr = (LAS float*)(L + wave * 16384);
        const int gw = vcu * NWAVES + wave, NGW = G * NWAVES;
        constexpr int I_ADA = ADA_KC * (NMOD / 256);
        constexpr int I_IN = (DM / 64) * (NINP / 32);
        constexpr int I_UQ = (QL / 64) * (NQ / 32);
        constexpr int I_UKV = (KVL / 64) * (NKV / 32);
        constexpr int I_OM = (DM / 64) * (DM / 32);
        constexpr int I_OP = (PW / 64) * (DM / 32);
        constexpr int I_OUT = (DM / 64) * (DM / 32);
        constexpr int I_PL = (256 / 64) * (PW / 32);
        constexpr int I_CS = MROWS * 32 / 64;
        constexpr int NITEMS = I_ADA + I_IN + I_UQ + I_UKV + I_OM + I_OP + I_OUT + I_PL + I_CS;
        for (int it = gw; it < NITEMS; it += NGW) {
            int r = it;
            if (r < I_ADA) {
                const int kc = r / 24, nc = r % 24, k0 = kc * ADA_KCH, n0 = nc * 256 + lane * 4;
                { const float c0 = args.c[k0 + lane], c1 = args.c[k0 + 64 + lane], d0 = args.c[DM + k0 + lane], d1 = args.c[DM + k0 + 64 + lane];
                  scr[lane] = silu_f(c0); scr[64 + lane] = silu_f(c1); scr[128 + lane] = silu_f(d0); scr[192 + lane] = silu_f(d1); }
                LDS_WAIT(); asm volatile("" ::: "memory");
                f32x4 a0 = {0.f, 0.f, 0.f, 0.f}, a1 = {0.f, 0.f, 0.f, 0.f};
#pragma unroll 8
                for (int kk = 0; kk < ADA_KCH; ++kk) { const f32x4 w = *(const f32x4*)(args.ada_w + (size_t)(k0 + kk) * NMOD + n0); a0 += w * scr[kk]; a1 += w * scr[128 + kk]; }
                *(f32x4*)(modp + ((size_t)(kc * 2 + 0)) * NMOD + n0) = a0; *(f32x4*)(modp + ((size_t)(kc * 2 + 1)) * NMOD + n0) = a1;
                LDS_WAIT(); asm volatile("" ::: "memory");
                continue; }
            r -= I_ADA;
            if (r < I_IN) { tr_item(args.w_in, NIN, Win, DM, 0, NINP / 32, 1, nullptr, nullptr, scr, r, lane); continue; } r -= I_IN;
            if (r < I_UQ) { tr_item(args.w_uq, NQ, Wuq, QL, 0, NQ / 32, 2, args.q_norm_g, nullptr, scr, r, lane); continue; } r -= I_UQ;
            if (r < I_UKV) { tr_item(args.w_ukv, NKV, Wukv, KVL, 0, NKV / 32, 0, args.kv_norm_g, nullptr, scr, r, lane); continue; } r -= I_UKV;
            if (r < I_OM) { tr_item(args.w_o_mla, DM, Wcat, 3072, 0, DM / 32, 0, nullptr, nullptr, scr, r, lane); continue; } r -= I_OM;
            if (r < I_OP) { tr_item(args.w_o_pool, DM, Wcat, 3072, 2048, DM / 32, 0, nullptr, nullptr, scr, r, lane); continue; } r -= I_OP;
            if (r < I_OUT) { tr_item(args.w_out, DM, Wout, DM, 0, DM / 32, 0, nullptr, nullptr, scr, r, lane); continue; } r -= I_OUT;
            if (r < I_PL) { tr_item(args.pool_w, 256, Wpool, 256, 0, PW / 32, 3, nullptr, args.pool_scale, scr, r, lane); continue; } r -= I_PL;
            {
                const int t = r * 2 + (lane >> 5), i = lane & 31;
                const float invf = 1.0f / powf(10000.0f, (float)(2 * i) / 64.0f);
                const float ang = (float)args.pos[t] * invf; float sn, cs_; sincos_acc(ang, sn, cs_);
                cstab[(size_t)t * 32 + i] = (f32x2){cs_, sn};
            }
        }
        if (BOTH(0)) GRID_BAR();
    }

    if (IN(1)) {
        const int lane = lane_id(), tid = wave * 64 + lane;
        LAS float* Gs = (LAS float*)L; LAS float* Ss = Gs + DM;
        for (int rb = vcu; rb < MROWS / 32; rb += G) {
            const int b = (rb * 32) / SEQ;
            __syncthreads();
            { const int k = tid * 4; f32x4 sc = *(const f32x4*)(args.ada_b + DM + k), sh = *(const f32x4*)(args.ada_b + k);
#pragma unroll
              for (int kc = 0; kc < ADA_KC; ++kc) { sc += *(const f32x4*)(modp + (size_t)(kc * 2 + b) * NMOD + DM + k); sh += *(const f32x4*)(modp + (size_t)(kc * 2 + b) * NMOD + k); }
              const f32x4 g = *(const f32x4*)(args.norm_g + k);
              *(LAS f32x4*)(Gs + k) = g * (sc + 1.0f); *(LAS f32x4*)(Ss + k) = sh; }
            __syncthreads();
#pragma unroll 1
            for (int rr = 0; rr < 4; ++rr) { const int row = rb * 32 + wave * 4 + rr;
                const f32x4* xr = (const f32x4*)(args.x + (size_t)row * DM) + lane; f32x4 v[8]; float s = 0.f;
#pragma unroll
                for (int j = 0; j < 8; ++j) { v[j] = xr[64 * j]; s += (v[j][0] * v[j][0] + v[j][1] * v[j][1]) + (v[j][2] * v[j][2] + v[j][3] * v[j][3]); }
                const float rstd = 1.0f / sqrtf(wave_sum(s) * (1.0f / DM) + EPS);
                v2u* o8 = (v2u*)(Hb + (size_t)row * DM) + lane;
#pragma unroll
                for (int j = 0; j < 8; ++j) { const f32x4 g = *(LAS f32x4*)(Gs + 256 * j + lane * 4), sh = *(LAS f32x4*)(Ss + 256 * j + lane * 4); const f32x4 hv = v[j] * rstd * g + sh;
                    v2u w; w.x = cvt_pk_bf16(hv[0], hv[1]); w.y = cvt_pk_bf16(hv[2], hv[3]); o8[64 * j] = w; }
            }
        }
        if (vcu < 48 && tid < 256) { const int b = tid >> 7, n = vcu * 128 + (tid & 127); float a = args.ada_b[n];
            for (int kc = 0; kc < ADA_KC; ++kc) a += modp[(size_t)(kc * 2 + b) * NMOD + n];
            modf[(size_t)b * NMOD + n] = a; }
        __syncthreads();
#ifdef DBG_POISON_MG
        { v4u* p = (v4u*)(ws + WS_MG); const v4u pz = {0xAAAAAAAAu, 0xAAAAAAAAu, 0xAAAAAAAAu, 0xAAAAAAAAu};
          for (size_t i = (size_t)bx * 512 + tid; i < (size_t)64 * MiB / 16; i += (size_t)G * 512) p[i] = pz; }
#endif
        if (BOTH(1)) GRID_BAR();
    }

    if (IN(2)) {
        pg8::Gemm g{Hb, Win, DM, DM, MROWS, NINP, DM}; pg8::StaticOrder S; S.init(MROWS, NINP, G, bx);
        pg8::EpiIn E{ZC, GMLA, VPOOL, GPOOL, MG, KRb, ssq1, cstab};
        pg8::gemm_phase<pg8::EpiIn, pg8::StaticOrder, true>(L, g, S, E, wave);
        if (BOTH(2)) GRID_BAR();
    }

    if (IN(3)) {
        {
            const int lane = lane_id();
            const int gw = vcu * NWAVES + wave, NGW = G * NWAVES;
            for (int it = gw; it < (MROWS / 8) * 2; it += NGW) {
                const int tb = it >> 1, half = it & 1, ch = half * 64 + lane, c0 = ch * 8, grp = c0 >> 8, hw = 1 << grp;
                const int t0 = tb * 8, b = t0 / SEQ, s0 = t0 % SEQ; const bf16_t* base = VPOOL + (size_t)b * SEQ * PW + c0;
                for (int i = 0; i < 8; ++i) { const int s = s0 + i; int lo_ = s - hw, hi_ = s + hw; lo_ = lo_ < 0 ? 0 : lo_; hi_ = hi_ > SEQ ? SEQ : hi_;
                    float a[8] = {0.f, 0.f, 0.f, 0.f, 0.f, 0.f, 0.f, 0.f};
                    for (int tt = lo_; tt < hi_; ++tt) { const v4u w = *(const v4u*)(base + (size_t)tt * PW);
                        a[0] += bf_lo(w.x); a[1] += bf_hi(w.x); a[2] += bf_lo(w.y); a[3] += bf_hi(w.y); a[4] += bf_lo(w.z); a[5] += bf_hi(w.z); a[6] += bf_lo(w.w); a[7] += bf_hi(w.w); }
                    const v4u sw = *(const v4u*)(base + (size_t)s * PW); const float inv = 1.0f / (float)(hi_ - lo_);
                    v4u o; o.x = cvt_pk_bf16(a[0] * inv - bf_lo(sw.x), a[1] * inv - bf_hi(sw.x)); o.y = cvt_pk_bf16(a[2] * inv - bf_lo(sw.y), a[3] * inv - bf_hi(sw.y));
                    o.z = cvt_pk_bf16(a[4] * inv - bf_lo(sw.z), a[5] * inv - bf_hi(sw.z)); o.w = cvt_pk_bf16(a[6] * inv - bf_lo(sw.w), a[7] * inv - bf_hi(sw.w));
                    *(v4u*)(POOLED + (size_t)(t0 + i) * PW + c0) = o; }
            }
            __syncthreads();
        }
        pg8::Gemm g{ZC, Wuq, 1024, 512, MROWS, NQ + NKV, 512}; pg8::StaticOrder S; S.init(MROWS, NQ + NKV, G, bx); S.ka_split = 12; S.ka_hi = 512;
        pg8::EpiQKV E{Qb, KVb, ssq1, cstab};
        pg8::gemm_phase<pg8::EpiQKV, pg8::StaticOrder, true>(L, g, S, E, wave);
        if (BOTH(3)) GRID_BAR();
    }

    if (IN(4)) {
#ifndef NO_POOLG
        {
            pg8::Gemm g{POOLED, Wpool, PW, 256, MROWS, PW, 256}; pg8::StaticOrder S; S.init(MROWS, PW, G, bx); S.ka_mul = 256;
            pg8::EpiGateBf16 E{ACAT, 3072, 2048, GPOOL, PW, 0};
            pg8::gemm_phase<pg8::EpiGateBf16, pg8::StaticOrder, true>(L, g, S, E, wave);
        }
        __syncthreads();
#endif
#ifndef NO_ATT
        for (int i = 0; ; ++i) { const int u = i * G + vcu; if (u >= BATCH * NH * (SEQ / 256)) break;
            const int bh = u >> 4, qb = u & 15;
            att::attn_unit(bh / NH, bh % NH, qb, Qb, KVb, KRb, GMLA, ACAT, (char*)lds, wave); }
#endif
        if (BOTH(4)) GRID_BAR();
    }

    if (IN(5)) {
        {
#ifdef DBG_P5A_ALT
            pg8::Gemm g{GMLA, Wout, 2048, 2048, MROWS, DM, DM}; pg8::StaticOrder S; S.init(MROWS, DM, G, bx);
#else
            pg8::Gemm g{ACAT, Wcat, 3072, 3072, MROWS, DM, DM}; pg8::StaticOrder S; S.init(MROWS, DM, G, bx);
#endif
#ifdef DBG_P5A_ALT
            pg8::EpiGateF32 E{Tb, ACAT, 3072, 0};
#else
            pg8::EpiGateF32 E{Tb, MG, 4096, 0};
#endif
            pg8::gemm_phase<pg8::EpiGateF32, pg8::StaticOrder, true>(L, g, S, E, wave);
        }
        VM_WAIT(); __syncthreads();
#ifndef DBG_P5A_ONLY
        {
            pg8::Gemm g{ACAT + 2048, Wcat + 2048, 3072, 3072, MROWS, DM, PW}; pg8::StaticOrder S; S.init(MROWS, DM, G, bx);
            pg8::EpiGateAddBf16 E{Yb, Tb, MG, 4096, 2048};
            pg8::gemm_phase<pg8::EpiGateAddBf16, pg8::StaticOrder, false>(L, g, S, E, wave);
        }
#endif
        if (BOTH(5)) GRID_BAR();
    }

    if (IN(6)) {
        pg8::Gemm g{Yb, Wout, DM, DM, MROWS, DM, DM}; pg8::StaticOrder S; S.init(MROWS, DM, G, bx);
        pg8::EpiOut E{args.x, args.out, modf, ssq2};
        pg8::gemm_phase<pg8::EpiOut, pg8::StaticOrder, false>(L, g, S, E, wave);
        if (BOTH(6)) GRID_BAR();
    }

    if (IN(7)) {
        const int lane = lane_id();
        const int gw = vcu * NWAVES + wave, NGW = G * NWAVES;
        for (int row = gw; row < MROWS; row += NGW) {
            float s = (lane < 32) ? ssq2[(size_t)row * 32 + lane] : 0.f; s = wave_sum(s);
            const float rstd = 1.0f / sqrtf(s * (1.0f / DM) + EPS);
            f32x4* o = (f32x4*)(args.out + (size_t)row * DM) + lane;
#pragma unroll
            for (int j = 0; j < 8; ++j) { const f32x4 g = *((const f32x4*)args.final_g + 64 * j + lane); o[64 * j] = o[64 * j] * rstd * g; }
        }
    }
#undef IN
#undef BOTH
#undef GRID_BAR
}


#ifdef DBG_STOP
__global__ void dbg_digest(Args args) {
    unsigned char* ws = args.ws; float* out = args.out;
    const bf16_t* Hb = (const bf16_t*)(ws + WS_H); const bf16_t* ZC = (const bf16_t*)(ws + WS_ZC); const bf16_t* VPOOL = (const bf16_t*)(ws + WS_VPOOL);
    const bf16_t* GMLA = (const bf16_t*)(ws + WS_GMLA); const bf16_t* GPOOL = (const bf16_t*)(ws + WS_GPOOL); const bf16_t* MG = (const bf16_t*)(ws + WS_MG);
    const bf16_t* KRb = (const bf16_t*)(ws + WS_KR); const bf16_t* POOLED = (const bf16_t*)(ws + WS_POOLED); const bf16_t* Qb = (const bf16_t*)(ws + WS_Q);
    const bf16_t* ACAT = (const bf16_t*)(ws + WS_ACAT); const bf16_t* Yb = (const bf16_t*)(ws + WS_Y); const float* ssq1 = (const float*)(ws + WS_SSQ1);
    const float* modp = (const float*)(ws + WS_MODP); const bf16_t* Win = (const bf16_t*)(ws + WS_WIN); const f32x2* cs = (const f32x2*)(ws + WS_CS);
    auto bf = [](bf16_t v) { return __uint_as_float((unsigned)v << 16); };
    for (size_t i = (size_t)blockIdx.x * blockDim.x + threadIdx.x; i < (size_t)MROWS * DM; i += (size_t)gridDim.x * blockDim.x) {
        const size_t r = i / DM, c = i % DM; float v = 0.f;
        if (DBG_STOP == 0) { v = bf(Win[i]) + ((i + (size_t)MROWS * DM < (size_t)NINP * DM) ? bf(Win[i + (size_t)MROWS * DM]) : 0.f); }
        if (DBG_STOP == 1) v = bf(Hb[i]);
        if (DBG_STOP == 2) v = ((MG[r * 4096 + c] == 0xAAAA) ? 1000.f : 0.f) + ((MG[r * 4096 + 2048 + c] == 0xAAAA) ? 1000.f : 0.f);
        if (DBG_STOP == 3) v = bf(MG[r * 4096 + c]) + bf(MG[r * 4096 + 2048 + c]);
        if (DBG_STOP == 4) v = bf(MG[r * 4096 + c]) + bf(MG[r * 4096 + 2048 + c]);
#ifdef DBG_P5A_ONLY
        if (DBG_STOP == 5) v = out[i];
#else
        if (DBG_STOP == 5) v = bf(Yb[i]);
#endif
        if (DBG_STOP == 6) v = out[i];
        out[i] = v;
    }
}
#endif
extern "C" void kernel_launch(void* const* d_in, const int* in_sizes, int n_in, void* d_out, int out_size, void* d_ws, size_t ws_size, hipStream_t stream) {
    static int grid = 0;
    if (grid == 0) {
        if (n_in != 17 || in_sizes[0] != MROWS * DM || out_size != MROWS * DM || ws_size < WS_END) {
            fprintf(stderr, "kernel_launch: shape mismatch n_in %d in0 %d out %d ws %zu (need %zu)\n", n_in, n_in > 0 ? in_sizes[0] : -1, out_size, ws_size, (size_t)WS_END); grid = -1; return; }
        int dev = 0, cus = 0;
        if (hipGetDevice(&dev) != hipSuccess || hipDeviceGetAttribute(&cus, hipDeviceAttributeMultiprocessorCount, dev) != hipSuccess) { grid = -1; return; }
        if (hipFuncSetAttribute((const void*)mk_fwd, hipFuncAttributeMaxDynamicSharedMemorySize, LDS_BYTES) != hipSuccess) { fprintf(stderr, "kernel_launch: hipFuncSetAttribute failed\n"); grid = -1; return; }
        int per_cu = 0;
        if (hipOccupancyMaxActiveBlocksPerMultiprocessor(&per_cu, (const void*)mk_fwd, NWAVES * 64, LDS_BYTES) != hipSuccess || per_cu < 1)
            fprintf(stderr, "kernel_launch: occupancy query reports %d blocks per CU\n", per_cu);
        (void)hipGetLastError();
        grid = cus;
    }
    if (grid < 0) return;
    (void)hipMemsetAsync((char*)d_ws + WS_CTL, 0, CTL_ZERO_BYTES, stream);
    Args a{};
    a.x = (const float*)d_in[0]; a.c = (const float*)d_in[1]; a.pos = (const int*)d_in[2]; a.ada_w = (const float*)d_in[3]; a.ada_b = (const float*)d_in[4];
    a.norm_g = (const float*)d_in[5]; a.w_in = (const float*)d_in[6]; a.q_norm_g = (const float*)d_in[7]; a.w_uq = (const float*)d_in[8]; a.kv_norm_g = (const float*)d_in[9];
    a.w_ukv = (const float*)d_in[10]; a.w_o_mla = (const float*)d_in[11]; a.pool_w = (const float*)d_in[12]; a.pool_scale = (const float*)d_in[13]; a.w_o_pool = (const float*)d_in[14];
    a.w_out = (const float*)d_in[15]; a.final_g = (const float*)d_in[16];
    a.out = (float*)d_out; a.ws = (unsigned char*)d_ws;
#if MK_N_LAUNCHES == 1
    a.ph_lo = 0; a.ph_hi = N_PHASES; a.li = 0;
    hipLaunchKernelGGL(mk_fwd, dim3(grid), dim3(NWAVES * 64), LDS_BYTES, stream, a);
#else
#ifdef DBG_STOP
    for (int li = 0; li <= DBG_STOP; ++li) { a.ph_lo = li; a.ph_hi = li + 1; a.li = li;
        hipLaunchKernelGGL(mk_fwd, dim3(grid), dim3(NWAVES * 64), LDS_BYTES, stream, a); }
    a.ph_lo = 0; a.ph_hi = 0;
    hipLaunchKernelGGL(dbg_digest, dim3(2048), dim3(256), 0, stream, a);
#else
    for (int li = 0; li < N_PHASES; ++li) { a.ph_lo = li; a.ph_hi = li + 1; a.li = li;
        hipLaunchKernelGGL(mk_fwd, dim3(grid), dim3(NWAVES * 64), LDS_BYTES, stream, a); }
#endif
#endif
    const hipError_t le = hipPeekAtLastError();
    if (le != hipSuccess) fprintf(stderr, "kernel_launch: launch failed: %s\n", hipGetErrorName(le));
}
```
